# Optimizing an MI355X kernel written in HIP

```python
import jax
import jax.numpy as jnp
from jax import lax
import numpy as np

D_MODEL = 1024
BATCH = 1
SEQ = 16384
DEPTH = 2
DEC_BATCH = 8
DEC_SEQ = 2048
PAST_LEN = 128

N_MEM = 256
ROPE_THETA = 500000.0
NORM_EPS = 1e-6
GLA_HEADS = 4
GLA_DK = D_MODEL // (2 * GLA_HEADS)
GLA_DV = D_MODEL // GLA_HEADS
GLA_GATE_RANK = 16
GLA_TAU = 16.0
GLA_CHUNK = 64
MLA_HEADS = 8
MLA_Q_RANK = D_MODEL // 4
MLA_KV_RANK = D_MODEL // 8
MLA_NOPE = 64
MLA_ROPE = 32
MLA_QK = MLA_NOPE + MLA_ROPE
MLA_V = D_MODEL // MLA_HEADS
Q_BLOCK = 128
DIL_GROUPS = ((128, 1), (512, 4), (2048, 16))
DIL_N_GROUPS = 3
DIL_HEADS = 8
DIL_HEAD_DIM = D_MODEL // DIL_HEADS
DIL_ROT = DIL_HEAD_DIM // 4
X_HEADS = 4
X_HEAD_DIM = D_MODEL // X_HEADS
D_FF = 4 * D_MODEL

IN_SPLITS = (
    GLA_HEADS * GLA_DK, GLA_HEADS * GLA_DK, GLA_HEADS * GLA_DV, GLA_HEADS * GLA_DV,
    GLA_GATE_RANK, GLA_GATE_RANK,
    MLA_Q_RANK, MLA_KV_RANK, MLA_ROPE,
    DIL_N_GROUPS * DIL_HEADS * DIL_HEAD_DIM, DIL_N_GROUPS * DIL_HEADS * DIL_HEAD_DIM,
    DIL_N_GROUPS * DIL_HEADS * DIL_HEAD_DIM,
    3 * D_MODEL,
)
IN_COLS = sum(IN_SPLITS)

kernel_name = "hybrid_bidir_gla_mla_dilated_encoder"


def rms_norm(x, g):
    xf = x.astype(jnp.float32)
    y = xf * lax.rsqrt(jnp.mean(xf * xf, axis=-1, keepdims=True) + NORM_EPS)
    return (y * g.astype(jnp.float32)).astype(x.dtype)


def split_cols(t, sizes):
    offs = np.cumsum(sizes)[:-1].tolist()
    return jnp.split(t, offs, axis=-1)


def rope_tables(seq_len, rot_dim):
    inv_freq = 1.0 / (ROPE_THETA ** (jnp.arange(0, rot_dim, 2, dtype=jnp.float32) / rot_dim))
    ang = jnp.arange(seq_len, dtype=jnp.float32)[:, None] * inv_freq[None, :]
    return jnp.cos(ang), jnp.sin(ang)


def apply_rope(x, cos, sin):
    half = cos.shape[-1]
    bshape = (1, cos.shape[0]) + (1,) * (x.ndim - 3) + (half,)
    c, s = cos.reshape(bshape), sin.reshape(bshape)
    xf = x.astype(jnp.float32)
    x1, x2 = xf[..., :half], xf[..., half:]
    return jnp.concatenate([x1 * c - x2 * s, x1 * s + x2 * c], axis=-1).astype(x.dtype)


def partial_rope(x, cos, sin, rot):
    return jnp.concatenate([apply_rope(x[..., :rot], cos, sin), x[..., rot:]], axis=-1)


def gla_chunked(q, k, v, log_a):
    B, S, H, dk = q.shape
    dv = v.shape[-1]
    n = S // GLA_CHUNK

    def chunks(t):
        return t.astype(jnp.float32).reshape(B, n, GLA_CHUNK, H, t.shape[-1])

    q, k, v, log_a = chunks(q), chunks(k), chunks(v), chunks(log_a)
    b = jnp.cumsum(log_a, axis=2)
    b_last = b[:, :, -1:]
    q_dec = q * jnp.exp(b)
    k_inv = k * jnp.exp(-b)
    k_tail = k * jnp.exp(b_last - b)
    lower = jnp.tril(jnp.ones((GLA_CHUNK, GLA_CHUNK), dtype=bool))
    att = jnp.where(lower, jnp.einsum("bnihd,bnjhd->bnhij", q_dec, k_inv), 0.0)
    o_intra = jnp.einsum("bnhij,bnjhe->bnihe", att, v)
    d_state = jnp.einsum("bnjhd,bnjhe->nbhde", k_tail, v)
    decay = jnp.exp(b_last[:, :, 0]).transpose(1, 0, 2, 3)

    def step(state, inp):
        ds_n, a_n = inp
        return a_n[..., None] * state + ds_n, state

    _, s_prev = lax.scan(step, jnp.zeros((B, H, dk, dv), jnp.float32), (d_state, decay))
    o_inter = jnp.einsum("bnihd,nbhde->bnihe", q_dec, s_prev)
    return (o_intra + o_inter).reshape(B, S, H, dv)


def gla_branch(a_q, a_k, a_v, a_r, a_gf, a_gb, w_gf, b_gf, w_gb, b_gb, g_out):
    B, S, _ = a_q.shape

    def heads(t, d):
        return t.reshape(B, S, GLA_HEADS, d)

    q = heads(a_q, GLA_DK) * (GLA_DK ** -0.5)
    k = heads(a_k, GLA_DK)
    v = heads(a_v, GLA_DV)
    log_af = heads(jax.nn.log_sigmoid((a_gf @ w_gf + b_gf).astype(jnp.float32)) / GLA_TAU, GLA_DK)
    log_ab = heads(jax.nn.log_sigmoid((a_gb @ w_gb + b_gb).astype(jnp.float32)) / GLA_TAU, GLA_DK)

    def flip(t):
        return jnp.flip(t, axis=1)

    o_f = gla_chunked(q, k, v, log_af)
    o_b = flip(gla_chunked(flip(q), flip(k), flip(v), flip(log_ab)))
    o = rms_norm(o_f + o_b, g_out).reshape(B, S, GLA_HEADS * GLA_DV)
    return (o * jax.nn.silu(a_r.astype(jnp.float32))).astype(a_q.dtype)


def blocked_softmax_attn(q, k, v, scale):
    B, S, H, dq = q.shape
    nb = S // Q_BLOCK
    qb = q.reshape(B, nb, Q_BLOCK, H, dq).transpose(1, 0, 2, 3, 4)
    vf = v.astype(jnp.float32)

    def attend(q_blk):
        s = jnp.einsum("bqhd,bkhd->bhqk", q_blk, k).astype(jnp.float32) * scale
        p = jax.nn.softmax(s, axis=-1)
        return jnp.einsum("bhqk,bkhe->bqhe", p, vf)

    o = lax.map(attend, qb)
    return o.transpose(1, 0, 2, 3, 4).reshape(B, S, H, v.shape[-1]).astype(q.dtype)


def mla_branch(b_q, b_kv, b_kpe, q_lat_norm, w_uq, kv_lat_norm, w_ukv, q_norm, k_norm, cos, sin):
    B, S, _ = b_q.shape
    q = (rms_norm(b_q, q_lat_norm) @ w_uq).reshape(B, S, MLA_HEADS, MLA_QK)
    kv = (rms_norm(b_kv, kv_lat_norm) @ w_ukv).reshape(B, S, MLA_HEADS, MLA_NOPE + MLA_V)
    k_nope, v = kv[..., :MLA_NOPE], kv[..., MLA_NOPE:]
    k_pe = jnp.broadcast_to(b_kpe[:, :, None, :], (B, S, MLA_HEADS, MLA_ROPE))
    k = jnp.concatenate([k_nope, k_pe], axis=-1)
    q = rms_norm(q, q_norm)
    k = rms_norm(k, k_norm)
    q = jnp.concatenate([q[..., :MLA_NOPE], apply_rope(q[..., MLA_NOPE:], cos, sin)], axis=-1)
    k = jnp.concatenate([k[..., :MLA_NOPE], apply_rope(k[..., MLA_NOPE:], cos, sin)], axis=-1)
    o = blocked_softmax_attn(q, k, v, MLA_QK ** -0.5)
    return o.reshape(B, S, MLA_HEADS * MLA_V)


def banded_attn(q, k, v, radius, scale):
    N, L, H, dh = q.shape
    blk = radius
    nb = -(-L // blk)
    lp = nb * blk
    qb = jnp.pad(q, ((0, 0), (0, lp - L), (0, 0), (0, 0))).reshape(N, nb, blk, H, dh)

    def windows(t):
        tb = jnp.pad(t, ((0, 0), (blk, lp - L + blk), (0, 0), (0, 0))).reshape(N, nb + 2, blk, H, t.shape[-1])
        return jnp.concatenate([tb[:, :-2], tb[:, 1:-1], tb[:, 2:]], axis=2)

    kw = windows(k)
    vw = windows(v).astype(jnp.float32)
    q_pos = jnp.arange(lp).reshape(nb, blk)
    k_pos = (jnp.arange(nb) * blk - blk)[:, None] + jnp.arange(3 * blk)[None, :]
    kp = k_pos[:, None, :]
    valid = (jnp.abs(q_pos[:, :, None] - kp) <= radius) & (kp >= 0) & (kp < L)
    s = jnp.einsum("nbqhd,nbkhd->nbhqk", qb, kw).astype(jnp.float32) * scale
    s = jnp.where(valid[None, :, None], s, -jnp.inf)
    m = jnp.max(s, axis=-1, keepdims=True)
    p = jnp.exp(s - m)
    l = jnp.sum(p, axis=-1)
    o = jnp.einsum("nbhqk,nbkhd->nbqhd", p, vw) / jnp.transpose(l, (0, 1, 3, 2))[..., None]
    lse = (m[..., 0] + jnp.log(l)).transpose(0, 1, 3, 2)
    return o.reshape(N, lp, H, dh)[:, :L], lse.reshape(N, lp, H)[:, :L]


def dilated_group(q, k, v, dilation, radius):
    B, S, H, dh = q.shape
    L = S // dilation

    def gather(t):
        e = t.shape[-1]
        return t.reshape(B, L, dilation, H, e).transpose(0, 2, 1, 3, 4).reshape(B * dilation, L, H, e)

    def scatter(t):
        e = t.shape[-1]
        return t.reshape(B, dilation, L, H, e).transpose(0, 2, 1, 3, 4).reshape(B, S, H, e)

    o, lse = banded_attn(gather(q), gather(k), gather(v), radius, dh ** -0.5)
    return scatter(o), scatter(lse[..., None])[..., 0]


def dilated_branch(c_q, c_k, c_v, q_norm, k_norm, cos, sin):
    B, S, _ = c_q.shape

    def heads(t):
        return t.reshape(B, S, DIL_N_GROUPS, DIL_HEADS, DIL_HEAD_DIM)

    q = partial_rope(rms_norm(heads(c_q), q_norm), cos, sin, DIL_ROT)
    k = partial_rope(rms_norm(heads(c_k), k_norm), cos, sin, DIL_ROT)
    v = heads(c_v)
    outs, lses = [], []
    for g, (window, dilation) in enumerate(DIL_GROUPS):
        o_g, lse_g = dilated_group(q[:, :, g], k[:, :, g], v[:, :, g], dilation, window // (2 * dilation))
        outs.append(o_g)
        lses.append(lse_g)
    o = jnp.stack(outs, axis=0)
    wgt = jax.nn.softmax(jnp.stack(lses, axis=0), axis=0)
    return jnp.sum(wgt[..., None] * o, axis=0).reshape(B, S, DIL_HEADS * DIL_HEAD_DIM).astype(c_q.dtype)


def memory_xattn(h, mem, norm_mem, w_xq, w_xkv, xq_norm, xk_norm, w_xo):
    B, S, _ = h.shape
    q = rms_norm((h @ w_xq).reshape(B, S, X_HEADS, X_HEAD_DIM), xq_norm)
    kv = rms_norm(mem, norm_mem) @ w_xkv
    k = rms_norm(kv[..., :D_MODEL].reshape(B, N_MEM, X_HEADS, X_HEAD_DIM), xk_norm)
    v = kv[..., D_MODEL:].reshape(B, N_MEM, X_HEADS, X_HEAD_DIM)
    s = jnp.einsum("bshd,bmhd->bhsm", q, k).astype(jnp.float32) * (X_HEAD_DIM ** -0.5)
    p = jax.nn.softmax(s, axis=-1)
    o = jnp.einsum("bhsm,bmhd->bshd", p, v.astype(jnp.float32)).astype(h.dtype)
    return o.reshape(B, S, D_MODEL) @ w_xo


def encoder_layer(x, mem, cos_mla, sin_mla, cos_dil, sin_dil,
                  norm_mix, w_in,
                  gla_w_gate_f, gla_b_gate_f, gla_w_gate_b, gla_b_gate_b, gla_out_norm, w_branch_a,
                  mla_q_lat_norm, mla_w_uq, mla_kv_lat_norm, mla_w_ukv, mla_q_norm, mla_k_norm, w_branch_b,
                  dil_q_norm, dil_k_norm, w_branch_c, w_out,
                  norm_xattn, norm_mem, w_xq, w_xkv, xq_norm, xk_norm, w_xo,
                  norm_ffn, w_ff1, w_ff2):
    h = rms_norm(x, norm_mix)
    (a_q, a_k, a_v, a_r, a_gf, a_gb, b_q, b_kv, b_kpe,
     c_q, c_k, c_v, gate_logits) = split_cols(h @ w_in, IN_SPLITS)
    y_a = gla_branch(a_q, a_k, a_v, a_r, a_gf, a_gb, gla_w_gate_f, gla_b_gate_f,
                     gla_w_gate_b, gla_b_gate_b, gla_out_norm) @ w_branch_a
    y_b = mla_branch(b_q, b_kv, b_kpe, mla_q_lat_norm, mla_w_uq, mla_kv_lat_norm, mla_w_ukv,
                     mla_q_norm, mla_k_norm, cos_mla, sin_mla) @ w_branch_b
    y_c = dilated_branch(c_q, c_k, c_v, dil_q_norm, dil_k_norm, cos_dil, sin_dil) @ w_branch_c
    g_a, g_b, g_c = jnp.split(jax.nn.sigmoid(gate_logits), 3, axis=-1)
    x = x + (g_a * y_a + g_b * y_b + g_c * y_c) @ w_out
    x = x + memory_xattn(rms_norm(x, norm_xattn), mem, norm_mem, w_xq, w_xkv, xq_norm, xk_norm, w_xo)
    x = x + jnp.square(jax.nn.relu(rms_norm(x, norm_ffn) @ w_ff1)) @ w_ff2
    return x


def setup_inputs(seed: int = 0) -> dict:
    key = jax.random.key(seed)
    ks = iter(jax.random.split(key, 48))

    def nrm(shape, scale):
        return jax.random.normal(next(ks), shape, jnp.float32) * scale

    def w(shape):
        return nrm(shape, shape[-2] ** -0.5)

    def g(shape):
        return 1.0 + nrm(shape, 0.02)

    L, D = DEPTH, D_MODEL
    return {
        "x_prompt": nrm((BATCH, SEQ, D), 1.0),
        "x_sample": nrm((DEC_BATCH, DEC_SEQ, D), 1.0),
        "mem_prompt": nrm((BATCH, N_MEM, D), 1.0),
        "mem_sample": nrm((DEC_BATCH, N_MEM, D), 1.0),
        "norm_mix": g((L, D)),
        "w_in": w((L, D, IN_COLS)),
        "gla_w_gate_f": w((L, GLA_GATE_RANK, GLA_HEADS * GLA_DK)),
        "gla_b_gate_f": nrm((L, GLA_HEADS * GLA_DK), 0.1),
        "gla_w_gate_b": w((L, GLA_GATE_RANK, GLA_HEADS * GLA_DK)),
        "gla_b_gate_b": nrm((L, GLA_HEADS * GLA_DK), 0.1),
        "gla_out_norm": g((L, GLA_DV)),
        "w_branch_a": w((L, GLA_HEADS * GLA_DV, D)),
        "mla_q_lat_norm": g((L, MLA_Q_RANK)),
        "mla_w_uq": w((L, MLA_Q_RANK, MLA_HEADS * MLA_QK)),
        "mla_kv_lat_norm": g((L, MLA_KV_RANK)),
        "mla_w_ukv": w((L, MLA_KV_RANK, MLA_HEADS * (MLA_NOPE + MLA_V))),
        "mla_q_norm": g((L, MLA_QK)),
        "mla_k_norm": g((L, MLA_QK)),
        "w_branch_b": w((L, MLA_HEADS * MLA_V, D)),
        "dil_q_norm": g((L, DIL_HEAD_DIM)),
        "dil_k_norm": g((L, DIL_HEAD_DIM)),
        "w_branch_c": w((L, DIL_HEADS * DIL_HEAD_DIM, D)),
        "w_out": w((L, D, D)),
        "norm_xattn": g((L, D)),
        "norm_mem": g((L, D)),
        "w_xq": w((L, D, D)),
        "w_xkv": w((L, D, 2 * D)),
        "xq_norm": g((L, X_HEAD_DIM)),
        "xk_norm": g((L, X_HEAD_DIM)),
        "w_xo": w((L, D, D)),
        "norm_ffn": g((L, D)),
        "w_ff1": w((L, D, D_FF)),
        "w_ff2": w((L, D_FF, D)),
    }


def reference(x_prompt, x_sample, mem_prompt, mem_sample,
              norm_mix, w_in,
              gla_w_gate_f, gla_b_gate_f, gla_w_gate_b, gla_b_gate_b, gla_out_norm, w_branch_a,
              mla_q_lat_norm, mla_w_uq, mla_kv_lat_norm, mla_w_ukv, mla_q_norm, mla_k_norm, w_branch_b,
              dil_q_norm, dil_k_norm, w_branch_c, w_out,
              norm_xattn, norm_mem, w_xq, w_xkv, xq_norm, xk_norm, w_xo,
              norm_ffn, w_ff1, w_ff2):
    def trunk(x, mem):
        S = x.shape[1]
        cos_mla, sin_mla = rope_tables(S, MLA_ROPE)
        cos_dil, sin_dil = rope_tables(S, DIL_ROT)
        for l in range(DEPTH):
            x = encoder_layer(
                x, mem, cos_mla, sin_mla, cos_dil, sin_dil,
                norm_mix[l], w_in[l],
                gla_w_gate_f[l], gla_b_gate_f[l], gla_w_gate_b[l], gla_b_gate_b[l], gla_out_norm[l], w_branch_a[l],
                mla_q_lat_norm[l], mla_w_uq[l], mla_kv_lat_norm[l], mla_w_ukv[l], mla_q_norm[l], mla_k_norm[l],
                w_branch_b[l],
                dil_q_norm[l], dil_k_norm[l], w_branch_c[l], w_out[l],
                norm_xattn[l], norm_mem[l], w_xq[l], w_xkv[l], xq_norm[l], xk_norm[l], w_xo[l],
                norm_ffn[l], w_ff1[l], w_ff2[l])
        return x

    y_prompt = trunk(x_prompt, mem_prompt)
    y_sample = trunk(x_sample, mem_sample)
    return (y_prompt, y_sample)
```

```cpp
#include <hip/hip_runtime.h>
#include <hip/hip_cooperative_groups.h>
#include <cstdio>
#include <cstdint>
namespace cg = cooperative_groups;

typedef unsigned short bf16_t;
typedef short bf16x8 __attribute__((ext_vector_type(8)));
typedef float f32x4 __attribute__((ext_vector_type(4)));
typedef unsigned u32x2 __attribute__((ext_vector_type(2)));
typedef unsigned u32x4 __attribute__((ext_vector_type(4)));

#ifndef PHMASK
#define PHMASK 0x3ffffffu
#endif
#define ON(n) ((PHMASK >> (n)) & 1u)
#ifndef MULTI_LAUNCH
#define MULTI_LAUNCH 0
#endif

constexpr int T = 32768, SP = 16384, SS = 2048, NMEMROW = 2304;
constexpr float EPS = 1e-6f;
constexpr size_t SLAB = 67108864ull;
constexpr int LDS_BYTES = 81408;

constexpr size_t OFF_W = 0;
constexpr size_t OFF_H = SLAB;
constexpr size_t OFF_R = 2 * SLAB;
constexpr size_t OFF_TAIL = 7 * SLAB;
constexpr size_t OFF_COS = OFF_TAIL;
constexpr size_t OFF_SIN = OFF_COS + 1048576;
constexpr size_t OFF_MEMH = OFF_SIN + 1048576;
constexpr size_t OFF_KX = OFF_MEMH + 4718592;
constexpr size_t OFF_VTX = OFF_KX + 4718592;
constexpr size_t OFF_LSE = OFF_VTX + 4718592;
constexpr size_t OFF_GG = OFF_LSE + 1048576;
constexpr size_t OFF_BAR = OFF_GG + 8388608;
constexpr size_t OFF_DBG = OFF_BAR + 256;
constexpr size_t WS_NEED = OFF_DBG + 16384;

constexpr size_t W_IN = 0;
constexpr size_t W_A = W_IN + 15808ull * 1024;
constexpr size_t W_B = W_A + 1048576;
constexpr size_t W_C = W_B + 1048576;
constexpr size_t W_O = W_C + 1048576;
constexpr size_t W_XQ = W_O + 1048576;
constexpr size_t W_XO = W_XQ + 1048576;
constexpr size_t W_XKV = W_XO + 1048576;
constexpr size_t W_F1 = W_XKV + 2097152;
constexpr size_t W_F2 = W_F1 + 4194304;
constexpr size_t W_UQ = W_F2 + 4194304;
constexpr size_t W_UKV = W_UQ + 196608;

struct Params {
  const float* in[33];
  float* out;
  char* ws;
};

__constant__ float c_inv_freq[16] = {1.000000000e+00f, 4.403666258e-01f, 1.939227581e-01f, 8.539710194e-02f, 3.760603070e-02f, 1.656044088e-02f,
                                     7.292665076e-03f, 3.211446106e-03f, 1.414213446e-03f, 6.227724371e-04f, 2.742481884e-04f, 1.207697424e-04f,
                                     5.318296462e-05f, 2.341999789e-05f, 1.031338525e-05f, 4.541670478e-06f};

typedef float f32x2_t __attribute__((ext_vector_type(2)));
typedef __bf16 bf16x2_t __attribute__((ext_vector_type(2)));
__device__ __forceinline__ unsigned cvt_pk(float lo, float hi) { f32x2_t v = {lo, hi}; bf16x2_t b = __builtin_convertvector(v, bf16x2_t); return __builtin_bit_cast(unsigned, b); }
__device__ __forceinline__ float bf_lo(unsigned u) { return __uint_as_float(u << 16); }
__device__ __forceinline__ float bf_hi(unsigned u) { return __uint_as_float(u & 0xffff0000u); }
__device__ __forceinline__ float bf2f(bf16_t h) { return __uint_as_float(((unsigned)h) << 16); }
__device__ __forceinline__ bf16_t f2bf(float f) { return (bf16_t)(cvt_pk(f, 0.f) & 0xffffu); }
__device__ __forceinline__ float wave_sum(float v) {
#pragma unroll
  for (int o = 32; o > 0; o >>= 1) v += __shfl_xor(v, o);
  return v;
}
__device__ __forceinline__ float sigmoidf_(float x) { return 1.f / (1.f + __expf(-x)); }
__device__ __forceinline__ int tok_pos(int t) { return t < SP ? t : ((t - SP) & (SS - 1)); }
__device__ __forceinline__ int perm2tok(int i, int d) {
  int base, S;
  if (i < SP) { base = 0; S = SP; } else { base = SP + ((i - SP) / SS) * SS; S = SS; }
  const int l = i - base, L = S / d;
  return base + (l % L) * d + (l / L);
}
__device__ __forceinline__ int otid() { int t = threadIdx.x; asm volatile("" : "+v"(t)); return t; }
__device__ __forceinline__ int obid() { int b = blockIdx.x; asm volatile("" : "+s"(b)); return b; }
typedef const float* cfptr_t;
__device__ __forceinline__ const float* pin(int i) {
  asm volatile("" : "+s"(i));
  const __attribute__((address_space(4))) cfptr_t* tbl = (const __attribute__((address_space(4))) cfptr_t*)__builtin_amdgcn_kernarg_segment_ptr();
  return tbl[i];
}
__device__ __forceinline__ float* pout() { return (float*)pin(33); }
__device__ __forceinline__ char* pws() { return (char*)pin(34); }
__device__ __forceinline__ f32x4 mfma16(bf16x8 a, bf16x8 b, f32x4 c) { return __builtin_amdgcn_mfma_f32_16x16x32_bf16(a, b, c, 0, 0, 0); }

struct ConvMat { const float* src; bf16_t* dst; const float* gain; int K, N, remap; };
__device__ __forceinline__ void conv_tile(char* lds, const ConvMat& cm, int tk, int tn) {
  bf16_t* L = (bf16_t*)lds;
  const int tid = otid();
  const int r = tid >> 4, c4 = tid & 15;
  __syncthreads();
#pragma unroll
  for (int i = 0; i < 4; ++i) {
    const int k = tk * 64 + r + 16 * i;
    f32x4 v = *(const f32x4*)(cm.src + (size_t)k * cm.N + tn * 64 + c4 * 4);
    if (cm.gain) { const float g = cm.gain[k]; v *= g; }
    const int kk = r + 16 * i;
    L[(c4 * 4 + 0) * 72 + kk] = f2bf(v[0]);
    L[(c4 * 4 + 1) * 72 + kk] = f2bf(v[1]);
    L[(c4 * 4 + 2) * 72 + kk] = f2bf(v[2]);
    L[(c4 * 4 + 3) * 72 + kk] = f2bf(v[3]);
  }
  __syncthreads();
  const int n = tid >> 2, kq = tid & 3;
  int ng = tn * 64 + n;
  if (cm.remap == 1) { const int h = ng / 192, j = ng % 192; ng = j < 64 ? h * 64 + j : 512 + h * 128 + (j - 64); }
  const u32x4 a = *(const u32x4*)(L + n * 72 + kq * 16);
  const u32x4 b = *(const u32x4*)(L + n * 72 + kq * 16 + 8);
  bf16_t* d = cm.dst + (size_t)ng * cm.K + tk * 64 + kq * 16;
  *(u32x4*)d = a;
  *(u32x4*)(d + 8) = b;
}

__device__ __forceinline__ void conv_phase(const Params& p, int layer, char* lds) {
  bf16_t* W = (bf16_t*)(pws() + OFF_W);
  for (int mi = 0; mi < 12; ++mi) {
    ConvMat cm; cm.gain = nullptr; cm.remap = 0;
    switch (mi) {
      case 0: cm.src = pin(5) + (size_t)layer * 1024 * 15808; cm.dst = W + W_IN; cm.K = 1024; cm.N = 15808; break;
      case 1: cm.src = pin(11) + (size_t)layer * 1048576; cm.dst = W + W_A; cm.K = 1024; cm.N = 1024; break;
      case 2: cm.src = pin(18) + (size_t)layer * 1048576; cm.dst = W + W_B; cm.K = 1024; cm.N = 1024; break;
      case 3: cm.src = pin(21) + (size_t)layer * 1048576; cm.dst = W + W_C; cm.K = 1024; cm.N = 1024; break;
      case 4: cm.src = pin(22) + (size_t)layer * 1048576; cm.dst = W + W_O; cm.K = 1024; cm.N = 1024; break;
      case 5: cm.src = pin(25) + (size_t)layer * 1048576; cm.dst = W + W_XQ; cm.K = 1024; cm.N = 1024; break;
      case 6: cm.src = pin(29) + (size_t)layer * 1048576; cm.dst = W + W_XO; cm.K = 1024; cm.N = 1024; break;
      case 7: cm.src = pin(26) + (size_t)layer * 2097152; cm.dst = W + W_XKV; cm.K = 1024; cm.N = 2048; break;
      case 8: cm.src = pin(31) + (size_t)layer * 4194304; cm.dst = W + W_F1; cm.K = 1024; cm.N = 4096; break;
      case 9: cm.src = pin(32) + (size_t)layer * 4194304; cm.dst = W + W_F2; cm.K = 4096; cm.N = 1024; break;
      case 10: cm.src = pin(13) + (size_t)layer * 196608; cm.dst = W + W_UQ; cm.K = 256; cm.N = 768; cm.gain = pin(12) + layer * 256; break;
      default: cm.src = pin(15) + (size_t)layer * 196608; cm.dst = W + W_UKV; cm.K = 128; cm.N = 1536; cm.remap = 1; break;
    }
    const int nk = cm.K / 64, nn = cm.N / 64, nt = nk * nn;
    for (int t = obid(); t < nt; t += gridDim.x) conv_tile(lds, cm, t / nn, t % nn);
  }
}

__device__ __forceinline__ void rope_phase(const Params& p) {
  float* C = (float*)(pws() + OFF_COS); float* S = (float*)(pws() + OFF_SIN);
  for (int i = obid() * 256 + otid(); i < 16384 * 16; i += gridDim.x * 256) {
    const int pos = i >> 4, f = i & 15;
    const float ang = (float)pos * c_inv_freq[f];
    double r = (double)ang * 0.15915494309189535;
    r -= floor(r);
    const float rf = (float)r;
    C[i] = __builtin_amdgcn_cosf(rf);
    S[i] = __builtin_amdgcn_sinf(rf);
  }
}

__device__ __forceinline__ void norm_rows(const float* src0, const float* src1, int split, int nrows, const float* g, bf16_t* dst, float* copy) {
  const int lane = otid() & 63, wid = otid() >> 6;
  for (int r = obid() * 4 + wid; r < nrows; r += gridDim.x * 4) {
    const float* s = r < split ? src0 + (size_t)r * 1024 : src1 + (size_t)(r - split) * 1024;
    f32x4 v[4]; float ss = 0.f;
#pragma unroll
    for (int i = 0; i < 4; ++i) { v[i] = *(const f32x4*)(s + i * 256 + lane * 4); ss += v[i][0] * v[i][0] + v[i][1] * v[i][1] + v[i][2] * v[i][2] + v[i][3] * v[i][3]; }
    ss = wave_sum(ss);
    const float rs = rsqrtf(ss * (1.f / 1024.f) + EPS);
#pragma unroll
    for (int i = 0; i < 4; ++i) {
      const f32x4 gg = *(const f32x4*)(g + i * 256 + lane * 4);
      u32x2 w; w.x = cvt_pk(v[i][0] * rs * gg[0], v[i][1] * rs * gg[1]); w.y = cvt_pk(v[i][2] * rs * gg[2], v[i][3] * rs * gg[3]);
      *(u32x2*)(dst + (size_t)r * 1024 + i * 256 + lane * 4) = w;
      if (copy) *(f32x4*)(copy + (size_t)r * 1024 + i * 256 + lane * 4) = v[i];
    }
  }
}

enum { MODE_ST = 0, MODE_VT = 1, MODE_RES = 2, MODE_RELU2 = 3, MODE_GATE = 4 };
enum { KIND_PROJA = 0, KIND_MEMKV, KIND_PROJB, KIND_UQ, KIND_UKV, KIND_MIX, KIND_PROJC, KIND_RES, KIND_XQ, KIND_FF1 };
enum { POST_NONE = 0, POST_NORM = 1, POST_NORMROPE = 2 };

struct GemmDesc {
  const bf16_t* A; const bf16_t* A2; const bf16_t* Bt; const bf16_t* Bt2;
  int lda, lda2, K, K2, mt, nt, npass;
  int adil;
  int bbase, bps, bpt, b2base;
  int kind, accum, layer;
};
struct EpiMode {
  int mode, ld, col0, post, ldt, frow0, tok0;
  bf16_t* ptr; const float* gain;
};

__device__ __forceinline__ EpiMode route(const Params& p, const GemmDesc& g, int tm, int tn) {
  EpiMode e; e.mode = MODE_ST; e.post = POST_NONE; e.gain = nullptr; e.ld = 1024; e.col0 = tn * 128; e.ldt = T; e.frow0 = 0; e.tok0 = tm * 128; e.ptr = nullptr;
  char* R = pws() + OFF_R;
  switch (g.kind) {
    case KIND_PROJA:
      if (tn < 4) { e.ptr = (bf16_t*)R; e.ld = 512; }
      else if (tn < 8) { e.ptr = (bf16_t*)(R + SLAB / 2); e.ld = 512; e.col0 = (tn - 4) * 128; }
      else if (tn < 16) { e.mode = MODE_VT; e.ptr = (bf16_t*)(R + SLAB); e.frow0 = (tn - 8) * 128; }
      else if (tn < 24) { e.ptr = (bf16_t*)(R + 2 * SLAB); e.col0 = (tn - 16) * 128; }
      else { e.ptr = (bf16_t*)(pws() + OFF_GG); e.ld = 128; e.col0 = 0; }
      break;
    case KIND_MEMKV:
      if (tn < 8) { e.ptr = (bf16_t*)(pws() + OFF_KX); }
      else { e.mode = MODE_VT; e.ptr = (bf16_t*)(pws() + OFF_VTX); e.ldt = 256; e.frow0 = (tm >> 1) * 1024 + (tn - 8) * 128; e.tok0 = (tm & 1) * 128; }
      break;
    case KIND_PROJB:
      e.ptr = (bf16_t*)R; e.ld = 512;
      if (tn == 2) { e.post = POST_NORM; e.gain = pin(14) + g.layer * 128; }
      break;
    case KIND_UQ: e.ptr = (bf16_t*)(R + SLAB); e.ld = 768; break;
    case KIND_UKV:
      if (tn < 4) { e.ptr = (bf16_t*)(R + SLAB / 2); e.ld = 512; }
      else { e.mode = MODE_VT; e.ptr = (bf16_t*)(R + 2 * SLAB + SLAB / 2); e.frow0 = (tn - 4) * 128; }
      break;
    case KIND_MIX: e.mode = MODE_GATE; e.ptr = (bf16_t*)(R + 4 * SLAB); break;
    case KIND_PROJC:
      if (tn < 8) { e.ptr = (bf16_t*)R; e.post = POST_NORMROPE; e.gain = pin(19) + g.layer * 128; }
      else if (tn < 16) { e.ptr = (bf16_t*)(R + SLAB); e.col0 = (tn - 8) * 128; e.post = POST_NORMROPE; e.gain = pin(20) + g.layer * 128; }
      else { e.mode = MODE_VT; e.ptr = (bf16_t*)(R + 2 * SLAB); e.frow0 = (tn - 16) * 128; }
      break;
    case KIND_RES: e.mode = MODE_RES; break;
    case KIND_XQ: e.ptr = (bf16_t*)R; break;
    default: e.mode = MODE_RELU2; e.ptr = (bf16_t*)R; e.ld = 4096; break;
  }
  return e;
}

__device__ __forceinline__ void gemm_phase(const Params& p, const GemmDesc& g, char* lds) {
  const int tid = otid(), lane = tid & 63, wid = tid >> 6, fr = lane & 15, fq = lane >> 4;
  const int wr = wid >> 1, wc = wid & 1;
  const int ntiles = g.mt * g.nt;
  const int lrow = tid >> 3, lkc = tid & 7;
  const float* cosT = (const float*)(pws() + OFF_COS); const float* sinT = (const float*)(pws() + OFF_SIN);
  for (int t = obid(); t < ntiles; t += gridDim.x) {
    const int tm = t / g.nt, tn = t % g.nt;
    const EpiMode em = route(p, g, tm, tn);
    const bool vt = em.mode == MODE_VT;
    const int offRow = vt ? 0 : 18432, offCol = vt ? 18432 : 0;
    const int rowBase = vt ? wr * 64 : wc * 64, colBase = vt ? wc * 64 : wr * 64;
    f32x4 acc[4][4];
#pragma unroll
    for (int i = 0; i < 4; ++i)
#pragma unroll
      for (int j = 0; j < 4; ++j) acc[i][j] = (f32x4){0.f, 0.f, 0.f, 0.f};
    unsigned gate[4][4][2];
#pragma unroll
    for (int i = 0; i < 4; ++i)
#pragma unroll
      for (int j = 0; j < 4; ++j) { gate[i][j][0] = 0; gate[i][j][1] = 0; }
    const int brow = g.bbase + (tn / g.bpt) * g.bps + (tn % g.bpt) * 128;
    for (int pass = 0; pass < g.npass; ++pass) {
      const bool gp = (g.npass == 2 && pass == 0);
      const bf16_t* Ab = gp ? g.A2 : g.A; const int lda = gp ? g.lda2 : g.lda;
      const bf16_t* Bb = gp ? g.Bt2 : g.Bt; const int K = gp ? g.K2 : g.K;
      const int br = gp ? g.b2base + tn * 128 : brow;
      const bf16_t* pa[4]; const bf16_t* pb[4];
#pragma unroll
      for (int i = 0; i < 4; ++i) {
        int ar = tm * 128 + lrow + 32 * i;
        if (g.adil > 0 && !gp) ar = perm2tok(ar, g.adil);
        else if (g.adil > 0 && gp) ar = perm2tok(ar, g.adil);
        pa[i] = Ab + (size_t)ar * lda + lkc * 8;
        pb[i] = Bb + (size_t)(br + lrow + 32 * i) * K + lkc * 8;
      }
      u32x4 ra[4], rb[4];
#pragma unroll
      for (int i = 0; i < 4; ++i) { ra[i] = *(const u32x4*)pa[i]; rb[i] = *(const u32x4*)pb[i]; }
      const int nk = K / 64;
      for (int kt = 0; kt < nk; ++kt) {
        __syncthreads();
#pragma unroll
        for (int i = 0; i < 4; ++i) {
          *(u32x4*)(lds + (lrow + 32 * i) * 144 + lkc * 16) = ra[i];
          *(u32x4*)(lds + 18432 + (lrow + 32 * i) * 144 + lkc * 16) = rb[i];
        }
        __syncthreads();
        if (kt + 1 < nk) {
#pragma unroll
          for (int i = 0; i < 4; ++i) { ra[i] = *(const u32x4*)(pa[i] + (kt + 1) * 64); rb[i] = *(const u32x4*)(pb[i] + (kt + 1) * 64); }
        }
#pragma unroll
        for (int ks = 0; ks < 2; ++ks) {
          bf16x8 fa[4], fb[4];
#pragma unroll
          for (int i = 0; i < 4; ++i) {
            fa[i] = *(const bf16x8*)(lds + offRow + (rowBase + i * 16 + fr) * 144 + ks * 64 + fq * 16);
            fb[i] = *(const bf16x8*)(lds + offCol + (colBase + i * 16 + fr) * 144 + ks * 64 + fq * 16);
          }
#pragma unroll
          for (int ci = 0; ci < 4; ++ci)
#pragma unroll
            for (int ri = 0; ri < 4; ++ri) acc[ci][ri] = mfma16(fa[ri], fb[ci], acc[ci][ri]);
        }
      }
      if (gp) {
#pragma unroll
        for (int ci = 0; ci < 4; ++ci)
#pragma unroll
          for (int ri = 0; ri < 4; ++ri) {
            const f32x4 a = acc[ci][ri];
            gate[ci][ri][0] = cvt_pk(sigmoidf_(a[0]), sigmoidf_(a[1]));
            gate[ci][ri][1] = cvt_pk(sigmoidf_(a[2]), sigmoidf_(a[3]));
            acc[ci][ri] = (f32x4){0.f, 0.f, 0.f, 0.f};
          }
      }
    }
    if (vt) {
#pragma unroll
      for (int ci = 0; ci < 4; ++ci)
#pragma unroll
        for (int ri = 0; ri < 4; ++ri) {
          const f32x4 a = acc[ci][ri];
          u32x2 w; w.x = cvt_pk(a[0], a[1]); w.y = cvt_pk(a[2], a[3]);
          *(u32x2*)(em.ptr + (size_t)(em.frow0 + wc * 64 + ci * 16 + fr) * em.ldt + em.tok0 + wr * 64 + ri * 16 + fq * 4) = w;
        }
    } else {
#pragma unroll
      for (int ci = 0; ci < 4; ++ci) {
        const int trow = tm * 128 + wr * 64 + ci * 16 + fr;
#pragma unroll
        for (int ri = 0; ri < 4; ++ri) {
          const int f = wc * 64 + ri * 16 + fq * 4;
          const f32x4 a = acc[ci][ri];
          if (em.mode == MODE_ST) {
            u32x2 w; w.x = cvt_pk(a[0], a[1]); w.y = cvt_pk(a[2], a[3]);
            *(u32x2*)(em.ptr + (size_t)trow * em.ld + em.col0 + f) = w;
          } else if (em.mode == MODE_RELU2) {
            const float r0 = fmaxf(a[0], 0.f), r1 = fmaxf(a[1], 0.f), r2 = fmaxf(a[2], 0.f), r3 = fmaxf(a[3], 0.f);
            u32x2 w; w.x = cvt_pk(r0 * r0, r1 * r1); w.y = cvt_pk(r2 * r2, r3 * r3);
            *(u32x2*)(em.ptr + (size_t)trow * em.ld + em.col0 + f) = w;
          } else if (em.mode == MODE_RES) {
            float* xp = pout() + (size_t)trow * 1024 + tn * 128 + f;
            f32x4 o = *(const f32x4*)xp; o += a; *(f32x4*)xp = o;
          } else {
            bf16_t* mp = em.ptr + (size_t)trow * 1024 + tn * 128 + f;
            const unsigned g0 = gate[ci][ri][0], g1 = gate[ci][ri][1];
            float v0 = bf_lo(g0) * a[0], v1 = bf_hi(g0) * a[1], v2 = bf_lo(g1) * a[2], v3 = bf_hi(g1) * a[3];
            if (g.accum) { const u32x2 o = *(const u32x2*)mp; v0 += bf_lo(o.x); v1 += bf_hi(o.x); v2 += bf_lo(o.y); v3 += bf_hi(o.y); }
            u32x2 w; w.x = cvt_pk(v0, v1); w.y = cvt_pk(v2, v3);
            *(u32x2*)mp = w;
          }
        }
      }
      if (em.post != POST_NONE) {
        asm volatile("s_waitcnt vmcnt(0)" ::: "memory"); __syncthreads(); asm volatile("buffer_inv sc1\n\ts_waitcnt vmcnt(0)" ::: "memory");
        for (int rr = 0; rr < 32; ++rr) {
          const int gi = tm * 128 + wid * 32 + rr;
          bf16_t* rp = em.ptr + (size_t)gi * em.ld + em.col0 + lane * 2;
          const unsigned u = *(const unsigned*)rp;
          float x0 = bf_lo(u), x1 = bf_hi(u);
          const float ss = wave_sum(x0 * x0 + x1 * x1);
          const float rs = rsqrtf(ss * (1.f / 128.f) + EPS);
          x0 *= rs * em.gain[lane * 2]; x1 *= rs * em.gain[lane * 2 + 1];
          if (em.post == POST_NORMROPE) {
            const int pos = tok_pos(perm2tok(gi, g.adil));
            const float p0 = __shfl_xor(x0, 8), p1 = __shfl_xor(x1, 8);
            if (lane < 16) {
              const int fi = (lane & 7) * 2;
              const float c0 = cosT[pos * 16 + fi], s0 = sinT[pos * 16 + fi], c1 = cosT[pos * 16 + fi + 1], s1 = sinT[pos * 16 + fi + 1];
              if (lane < 8) { x0 = x0 * c0 - p0 * s0; x1 = x1 * c1 - p1 * s1; }
              else { x0 = p0 * s0 + x0 * c0; x1 = p1 * s1 + x1 * c1; }
            }
          }
          *(unsigned*)rp = cvt_pk(x0, x1);
        }
      }
    }
  }
}

template <int DQK, int MODE, int QT>
__device__ __forceinline__ void attn_unit(const Params& p, char* lds, const bf16_t* qptr, int ldq, const bf16_t* kptr, int ldk, const bf16_t* vptr, int ldv,
                                          int tb, int te, int qi0, float scale, const float* qgain,
                                          bf16_t* optr, int ldo, int grp, int otokbase, int head, int dil) {
  constexpr int DV = 128, SK = DQK + 8, NKS = DQK / 32, CR = DQK / 8, NKC = (64 * CR) / 256;
  constexpr int VOFF = 64 * SK * 2;
  const int tid = otid(), lane = tid & 63, wid = tid >> 6, fr = lane & 15, fq = lane >> 4;
  bf16x8 qf[QT][NKS];
  {
    const float sc = scale * 1.4426950408889634f;
#pragma unroll
    for (int qt = 0; qt < QT; ++qt) {
      const bf16_t* qr = qptr + (size_t)(wid * (QT * 16) + qt * 16 + fr) * ldq + fq * 8;
      u32x4 raw[NKS]; float ss = 0.f;
#pragma unroll
      for (int ks = 0; ks < NKS; ++ks) {
        raw[ks] = *(const u32x4*)(qr + ks * 32);
        if (MODE == 2) {
#pragma unroll
          for (int e = 0; e < 4; ++e) { const float a = bf_lo(raw[ks][e]), b = bf_hi(raw[ks][e]); ss += a * a + b * b; }
        }
      }
      float rs = sc;
      if (MODE == 2) { ss += __shfl_xor(ss, 16); ss += __shfl_xor(ss, 32); rs = sc * rsqrtf(ss * (1.f / DQK) + EPS); }
#pragma unroll
      for (int ks = 0; ks < NKS; ++ks) {
        u32x4 o;
#pragma unroll
        for (int e = 0; e < 4; ++e) {
          float a = bf_lo(raw[ks][e]) * rs, b = bf_hi(raw[ks][e]) * rs;
          if (MODE == 2) { a *= qgain[ks * 32 + fq * 8 + e * 2]; b *= qgain[ks * 32 + fq * 8 + e * 2 + 1]; }
          o[e] = cvt_pk(a, b);
        }
        qf[qt][ks] = __builtin_bit_cast(bf16x8, o);
      }
    }
  }
  f32x4 ot[8][QT];
#pragma unroll
  for (int v = 0; v < 8; ++v)
#pragma unroll
    for (int qt = 0; qt < QT; ++qt) ot[v][qt] = (f32x4){0.f, 0.f, 0.f, 0.f};
  float mrun[QT], lsum[QT];
#pragma unroll
  for (int qt = 0; qt < QT; ++qt) { mrun[qt] = -1e30f; lsum[qt] = 0.f; }
  u32x4 rk[NKC], rv[4];
  auto issue = [&](int tile) {
#pragma unroll
    for (int i = 0; i < NKC; ++i) { const int c = tid + 256 * i, row = c / CR, kc = c % CR; rk[i] = *(const u32x4*)(kptr + (size_t)(tile * 64 + row) * ldk + kc * 8); }
#pragma unroll
    for (int i = 0; i < 4; ++i) { const int c = tid + 256 * i, row = c >> 3, kc = c & 7; rv[i] = *(const u32x4*)(vptr + (size_t)row * ldv + tile * 64 + kc * 8); }
  };
  if (tb < te) issue(tb);
  const int wq0 = qi0 + wid * (QT * 16);
  for (int tile = tb; tile < te; ++tile) {
    __syncthreads();
#pragma unroll
    for (int i = 0; i < NKC; ++i) { const int c = tid + 256 * i, row = c / CR, kc = c % CR; *(u32x4*)(lds + row * (SK * 2) + kc * 16) = rk[i]; }
#pragma unroll
    for (int i = 0; i < 4; ++i) { const int c = tid + 256 * i, row = c >> 3, kc = c & 7; *(u32x4*)(lds + VOFF + row * 144 + kc * 16) = rv[i]; }
    __syncthreads();
    if (tile + 1 < te) issue(tile + 1);
    const int t0 = tile * 64;
    if (MODE == 1) { if (t0 + 63 < wq0 - 64 || t0 > wq0 + QT * 16 - 1 + 64) continue; }
    f32x4 st[4][QT];
#pragma unroll
    for (int kt = 0; kt < 4; ++kt)
#pragma unroll
      for (int qt = 0; qt < QT; ++qt) st[kt][qt] = (f32x4){0.f, 0.f, 0.f, 0.f};
#pragma unroll
    for (int ks = 0; ks < NKS; ++ks)
#pragma unroll
      for (int kt = 0; kt < 4; ++kt) {
        const bf16x8 a = *(const bf16x8*)(lds + (kt * 16 + fr) * (SK * 2) + ks * 64 + fq * 16);
#pragma unroll
        for (int qt = 0; qt < QT; ++qt) st[kt][qt] = mfma16(a, qf[qt][ks], st[kt][qt]);
      }
    bf16x8 pf[2][QT];
#pragma unroll
    for (int qt = 0; qt < QT; ++qt) {
      if (MODE == 1) {
        const int qi = wq0 + qt * 16 + fr;
#pragma unroll
        for (int kt = 0; kt < 4; ++kt)
#pragma unroll
          for (int j = 0; j < 4; ++j) { const int dk = t0 + kt * 16 + fq * 4 + j - qi; if (dk > 64 || dk < -64) st[kt][qt][j] = -1e30f; }
      }
      float mx = -1e30f;
#pragma unroll
      for (int kt = 0; kt < 4; ++kt) mx = fmaxf(mx, fmaxf(fmaxf(st[kt][qt][0], st[kt][qt][1]), fmaxf(st[kt][qt][2], st[kt][qt][3])));
      mx = fmaxf(mx, __shfl_xor(mx, 16)); mx = fmaxf(mx, __shfl_xor(mx, 32));
      const float mnew = fmaxf(mrun[qt], mx);
      const float alpha = __builtin_amdgcn_exp2f(mrun[qt] - mnew);
      mrun[qt] = mnew;
      float ps = 0.f;
      unsigned pk[4][2];
#pragma unroll
      for (int kt = 0; kt < 4; ++kt) {
        const float p0 = __builtin_amdgcn_exp2f(st[kt][qt][0] - mnew), p1 = __builtin_amdgcn_exp2f(st[kt][qt][1] - mnew), p2 = __builtin_amdgcn_exp2f(st[kt][qt][2] - mnew), p3 = __builtin_amdgcn_exp2f(st[kt][qt][3] - mnew);
        ps += (p0 + p1) + (p2 + p3);
        pk[kt][0] = cvt_pk(p0, p1); pk[kt][1] = cvt_pk(p2, p3);
      }
      lsum[qt] = lsum[qt] * alpha + ps;
#pragma unroll
      for (int v = 0; v < 8; ++v) ot[v][qt] *= alpha;
#pragma unroll
      for (int c = 0; c < 2; ++c) { u32x4 o; o[0] = pk[2 * c][0]; o[1] = pk[2 * c][1]; o[2] = pk[2 * c + 1][0]; o[3] = pk[2 * c + 1][1]; pf[c][qt] = __builtin_bit_cast(bf16x8, o); }
    }
#pragma unroll
    for (int v = 0; v < 8; ++v)
#pragma unroll
      for (int c = 0; c < 2; ++c) {
        const char* vb = lds + VOFF + (v * 16 + fr) * 144 + c * 64 + fq * 8;
        const u32x2 lo = *(const u32x2*)vb, hi = *(const u32x2*)(vb + 32);
        u32x4 o; o[0] = lo.x; o[1] = lo.y; o[2] = hi.x; o[3] = hi.y;
        const bf16x8 a = __builtin_bit_cast(bf16x8, o);
#pragma unroll
        for (int qt = 0; qt < QT; ++qt) ot[v][qt] = mfma16(a, pf[c][qt], ot[v][qt]);
      }
  }
#pragma unroll
  for (int qt = 0; qt < QT; ++qt) {
    float l = lsum[qt]; l += __shfl_xor(l, 16); l += __shfl_xor(l, 32);
    const float inv = 1.f / l;
    const int qrow = wid * (QT * 16) + qt * 16 + fr;
    if (MODE == 1) {
      const int tok = perm2tok(otokbase + qrow, dil);
      const float lse = (mrun[qt] + __log2f(l)) * 0.6931471805599453f;
      float* lp = (float*)(pws() + OFF_LSE) + (size_t)head * T + tok;
      float wo = 0.f, wn = 1.f, nl = lse;
      if (grp > 0) { const float lo = *lp; const float mm = fmaxf(lo, lse); nl = mm + __logf(__expf(lo - mm) + __expf(lse - mm)); wo = __expf(lo - nl); wn = __expf(lse - nl); }
      bf16_t* op = optr + (size_t)tok * ldo + fq * 4;
#pragma unroll
      for (int v = 0; v < 8; ++v) {
        f32x4 o = ot[v][qt] * (inv * wn);
        if (grp > 0) { const u32x2 old = *(const u32x2*)(op + v * 16); o[0] += wo * bf_lo(old.x); o[1] += wo * bf_hi(old.x); o[2] += wo * bf_lo(old.y); o[3] += wo * bf_hi(old.y); }
        u32x2 w; w.x = cvt_pk(o[0], o[1]); w.y = cvt_pk(o[2], o[3]);
        *(u32x2*)(op + v * 16) = w;
      }
      if (fq == 0) *lp = nl;
    } else {
      bf16_t* op = optr + (size_t)qrow * ldo + fq * 4;
#pragma unroll
      for (int v = 0; v < 8; ++v) {
        const f32x4 o = ot[v][qt] * inv;
        u32x2 w; w.x = cvt_pk(o[0], o[1]); w.y = cvt_pk(o[2], o[3]);
        *(u32x2*)(op + v * 16) = w;
      }
    }
  }
}

__device__ __forceinline__ void gla_unit(const Params& p, char* lds, int layer, int sid, int head, int dir, int sl) {
  constexpr int QD = 0, KI = 17408, KT = 34816, VT = 53248, STO = 62464, DEC = 79872, TOT = 80384;
  const int tid = otid(), lane = tid & 63, wid = tid >> 6, fr = lane & 15, fq = lane >> 4;
  const int d = tid & 127, hf = tid >> 7;
  const int seqbase = sid == 0 ? 0 : SP + (sid - 1) * SS, S = sid == 0 ? SP : SS, nch = S / 64;
  char* R = pws() + OFF_R;
  const bf16_t* Q = (const bf16_t*)R; const bf16_t* Kp = (const bf16_t*)(R + SLAB / 2); const bf16_t* VAT = (const bf16_t*)(R + SLAB);
  const bf16_t* GG = (const bf16_t*)(pws() + OFF_GG);
  bf16_t* O = (bf16_t*)(R + (dir ? 4 : 3) * SLAB);
  const float* wg = pin(dir ? 8 : 6) + (size_t)layer * 16 * 512 + head * 128 + d;
  float w[16];
#pragma unroll
  for (int r = 0; r < 16; ++r) w[r] = wg[r * 512];
  const float bias = pin(dir ? 9 : 7)[layer * 512 + head * 128 + d];
  f32x4 sacc[8];
#pragma unroll
  for (int i = 0; i < 8; ++i) sacc[i] = (f32x4){0.f, 0.f, 0.f, 0.f};
  __syncthreads();
  for (int i = tid; i < 17408 / 4; i += 256) ((unsigned*)(lds + STO))[i] = 0u;
  const float qscale = 0.08838834764831845f;
  for (int n = 0; n < nch; ++n) {
    const int ch = dir ? nch - 1 - n : n;
    const int tb = seqbase + ch * 64;
    float tot = 0.f;
    for (int tt = 0; tt < 32; ++tt) {
      const int tk = tb + hf * 32 + tt;
      const u32x4 g0 = *(const u32x4*)(GG + (size_t)tk * 128 + dir * 16), g1 = *(const u32x4*)(GG + (size_t)tk * 128 + dir * 16 + 8);
      float z = bias;
#pragma unroll
      for (int e = 0; e < 4; ++e) { z += bf_lo(g0[e]) * w[2 * e] + bf_hi(g0[e]) * w[2 * e + 1]; z += bf_lo(g1[e]) * w[8 + 2 * e] + bf_hi(g1[e]) * w[8 + 2 * e + 1]; }
      const float la = (fminf(z, 0.f) - __logf(1.f + __expf(-fabsf(z)))) * (1.f / 16.f);
      tot += la;
    }
    __syncthreads();
    ((float*)(lds + TOT))[hf * 128 + d] = tot;
#pragma unroll
    for (int i = 0; i < 2; ++i) {
      const int c = tid + 256 * i, row = c >> 3, kc = c & 7;
      *(u32x4*)(lds + VT + row * 144 + kc * 16) = *(const u32x4*)(VAT + (size_t)(head * 256 + sl * 64 + row) * T + tb + kc * 8);
    }
    __syncthreads();
    const float other = ((const float*)(lds + TOT))[(1 - hf) * 128 + d];
    const float blast = tot + other;
    if (hf == 0) ((float*)(lds + DEC))[d] = __expf(blast);
    float run = dir ? (hf == 0 ? other : 0.f) : (hf == 1 ? other : 0.f);
    for (int t2 = 0; t2 < 16; ++t2) {
      float bb[2]; float qv[2], kv[2];
#pragma unroll
      for (int e2 = 0; e2 < 2; ++e2) {
        const int tt = dir ? 31 - (t2 * 2 + e2) : t2 * 2 + e2;
        const int tk = tb + hf * 32 + tt;
        const u32x4 g0 = *(const u32x4*)(GG + (size_t)tk * 128 + dir * 16), g1 = *(const u32x4*)(GG + (size_t)tk * 128 + dir * 16 + 8);
        float z = bias;
#pragma unroll
        for (int e = 0; e < 4; ++e) { z += bf_lo(g0[e]) * w[2 * e] + bf_hi(g0[e]) * w[2 * e + 1]; z += bf_lo(g1[e]) * w[8 + 2 * e] + bf_hi(g1[e]) * w[8 + 2 * e + 1]; }
        const float la = (fminf(z, 0.f) - __logf(1.f + __expf(-fabsf(z)))) * (1.f / 16.f);
        run += la; bb[e2] = run;
        qv[e2] = bf2f(Q[(size_t)tk * 512 + head * 128 + d]); kv[e2] = bf2f(Kp[(size_t)tk * 512 + head * 128 + d]);
        const int tl = hf * 32 + tt;
        ((bf16_t*)(lds + QD))[tl * 136 + d] = f2bf(qv[e2] * qscale * __expf(run));
        ((bf16_t*)(lds + KI))[tl * 136 + d] = f2bf(kv[e2] * __expf(-run));
      }
      const float k0 = kv[0] * __expf(blast - bb[0]), k1 = kv[1] * __expf(blast - bb[1]);
      const int tl0 = hf * 32 + (dir ? 31 - (t2 * 2 + 1) : t2 * 2);
      *(unsigned*)(lds + KT + d * 144 + tl0 * 2) = dir ? cvt_pk(k1, k0) : cvt_pk(k0, k1);
    }
    __syncthreads();
    {
      f32x4 at[4];
#pragma unroll
      for (int jt = 0; jt < 4; ++jt) at[jt] = (f32x4){0.f, 0.f, 0.f, 0.f};
      bf16x8 qfr[4];
#pragma unroll
      for (int ks = 0; ks < 4; ++ks) qfr[ks] = *(const bf16x8*)(lds + QD + (wid * 16 + fr) * 272 + ks * 64 + fq * 16);
#pragma unroll
      for (int ks = 0; ks < 4; ++ks)
#pragma unroll
        for (int jt = 0; jt < 4; ++jt) {
          const bf16x8 a = *(const bf16x8*)(lds + KI + (jt * 16 + fr) * 272 + ks * 64 + fq * 16);
          at[jt] = mfma16(a, qfr[ks], at[jt]);
        }
      const int qi = wid * 16 + fr;
      bf16x8 pf[2];
      {
        unsigned pk[4][2];
#pragma unroll
        for (int jt = 0; jt < 4; ++jt) {
          float v[4];
#pragma unroll
          for (int j = 0; j < 4; ++j) { const int kj = jt * 16 + fq * 4 + j; const bool ok = dir ? (kj >= qi) : (kj <= qi); v[j] = ok ? at[jt][j] : 0.f; }
          pk[jt][0] = cvt_pk(v[0], v[1]); pk[jt][1] = cvt_pk(v[2], v[3]);
        }
#pragma unroll
        for (int c = 0; c < 2; ++c) { u32x4 o; o[0] = pk[2 * c][0]; o[1] = pk[2 * c][1]; o[2] = pk[2 * c + 1][0]; o[3] = pk[2 * c + 1][1]; pf[c] = __builtin_bit_cast(bf16x8, o); }
      }
      f32x4 ot[4];
#pragma unroll
      for (int et = 0; et < 4; ++et) {
        ot[et] = (f32x4){0.f, 0.f, 0.f, 0.f};
#pragma unroll
        for (int c = 0; c < 2; ++c) {
          const char* vb = lds + VT + (et * 16 + fr) * 144 + c * 64 + fq * 8;
          const u32x2 lo = *(const u32x2*)vb, hi = *(const u32x2*)(vb + 32);
          u32x4 o; o[0] = lo.x; o[1] = lo.y; o[2] = hi.x; o[3] = hi.y;
          ot[et] = mfma16(__builtin_bit_cast(bf16x8, o), pf[c], ot[et]);
        }
#pragma unroll
        for (int ks = 0; ks < 4; ++ks) {
          const bf16x8 a = *(const bf16x8*)(lds + STO + (et * 16 + fr) * 272 + ks * 64 + fq * 16);
          ot[et] = mfma16(a, qfr[ks], ot[et]);
        }
        u32x2 wv; wv.x = cvt_pk(ot[et][0], ot[et][1]); wv.y = cvt_pk(ot[et][2], ot[et][3]);
        *(u32x2*)(O + (size_t)(tb + qi) * 1024 + head * 256 + sl * 64 + et * 16 + fq * 4) = wv;
      }
      bf16x8 vb2[2];
#pragma unroll
      for (int ks = 0; ks < 2; ++ks) vb2[ks] = *(const bf16x8*)(lds + VT + (wid * 16 + fr) * 144 + ks * 64 + fq * 16);
#pragma unroll
      for (int dt = 0; dt < 8; ++dt) {
        const f32x4 dc = *(const f32x4*)(lds + DEC + (dt * 16 + fq * 4) * 4);
        sacc[dt] *= dc;
#pragma unroll
        for (int ks = 0; ks < 2; ++ks) {
          const bf16x8 a = *(const bf16x8*)(lds + KT + (dt * 16 + fr) * 144 + ks * 64 + fq * 16);
          sacc[dt] = mfma16(a, vb2[ks], sacc[dt]);
        }
      }
    }
    __syncthreads();
#pragma unroll
    for (int dt = 0; dt < 8; ++dt) {
      u32x2 wv; wv.x = cvt_pk(sacc[dt][0], sacc[dt][1]); wv.y = cvt_pk(sacc[dt][2], sacc[dt][3]);
      *(u32x2*)(lds + STO + (wid * 16 + fr) * 272 + (dt * 16 + fq * 4) * 2) = wv;
    }
  }
}

__device__ __forceinline__ void gla_post(const Params& p, int layer) {
  char* R = pws() + OFF_R;
  bf16_t* OF = (bf16_t*)(R + 3 * SLAB); const bf16_t* OB = (const bf16_t*)(R + 4 * SLAB); const bf16_t* RA = (const bf16_t*)(R + 2 * SLAB);
  const int lane = otid() & 63, wid = otid() >> 6;
  const f32x4 g = *(const f32x4*)(pin(10) + layer * 256 + lane * 4);
  for (int r = obid() * 4 + wid; r < T * 4; r += gridDim.x * 4) {
    const size_t off = (size_t)r * 256 + lane * 4;
    const u32x2 a = *(const u32x2*)(OF + off), b = *(const u32x2*)(OB + off), rr = *(const u32x2*)(RA + off);
    float v0 = bf_lo(a.x) + bf_lo(b.x), v1 = bf_hi(a.x) + bf_hi(b.x), v2 = bf_lo(a.y) + bf_lo(b.y), v3 = bf_hi(a.y) + bf_hi(b.y);
    const float ss = wave_sum(v0 * v0 + v1 * v1 + v2 * v2 + v3 * v3);
    const float rs = rsqrtf(ss * (1.f / 256.f) + EPS);
    const float r0 = bf_lo(rr.x), r1 = bf_hi(rr.x), r2 = bf_lo(rr.y), r3 = bf_hi(rr.y);
    v0 *= rs * g[0] * r0 * sigmoidf_(r0); v1 *= rs * g[1] * r1 * sigmoidf_(r1); v2 *= rs * g[2] * r2 * sigmoidf_(r2); v3 *= rs * g[3] * r3 * sigmoidf_(r3);
    u32x2 w; w.x = cvt_pk(v0, v1); w.y = cvt_pk(v2, v3);
    *(u32x2*)(OF + off) = w;
  }
}

__device__ __forceinline__ void mem_post(const Params& p, int layer) {
  bf16_t* KX = (bf16_t*)(pws() + OFF_KX);
  const int lane = otid() & 63, wid = otid() >> 6;
  const f32x4 g = *(const f32x4*)(pin(28) + layer * 256 + lane * 4);
  for (int r = obid() * 4 + wid; r < NMEMROW * 4; r += gridDim.x * 4) {
    const size_t off = (size_t)r * 256 + lane * 4;
    const u32x2 a = *(const u32x2*)(KX + off);
    float v0 = bf_lo(a.x), v1 = bf_hi(a.x), v2 = bf_lo(a.y), v3 = bf_hi(a.y);
    const float ss = wave_sum(v0 * v0 + v1 * v1 + v2 * v2 + v3 * v3);
    const float rs = rsqrtf(ss * (1.f / 256.f) + EPS);
    u32x2 w; w.x = cvt_pk(v0 * rs * g[0], v1 * rs * g[1]); w.y = cvt_pk(v2 * rs * g[2], v3 * rs * g[3]);
    *(u32x2*)(KX + off) = w;
  }
}

__device__ __forceinline__ void mla_post(const Params& p, int layer) {
  char* R = pws() + OFF_R;
  const bf16_t* PB = (const bf16_t*)R; const bf16_t* KN = (const bf16_t*)(R + SLAB / 2);
  bf16_t* QM = (bf16_t*)(R + SLAB); bf16_t* KM = (bf16_t*)(R + SLAB + 50331648ull);
  const float* cosT = (const float*)(pws() + OFF_COS); const float* sinT = (const float*)(pws() + OFF_SIN);
  const int lane = otid() & 63, wid = otid() >> 6;
  const float* qn = pin(16) + layer * 96; const float* kn = pin(17) + layer * 96;
  const bool act = lane < 48;
  const float gq0 = act ? qn[lane * 2] : 0.f, gq1 = act ? qn[lane * 2 + 1] : 0.f, gk0 = act ? kn[lane * 2] : 0.f, gk1 = act ? kn[lane * 2 + 1] : 0.f;
  const int fi = (lane & 7) * 2;
  for (int t = obid() * 4 + wid; t < T; t += gridDim.x * 4) {
    const int pos = tok_pos(t);
    float c0 = 0.f, s0 = 0.f, c1 = 0.f, s1 = 0.f;
    if (lane >= 32 && lane < 48) { c0 = cosT[pos * 16 + fi]; s0 = sinT[pos * 16 + fi]; c1 = cosT[pos * 16 + fi + 1]; s1 = sinT[pos * 16 + fi + 1]; }
    const u32x2 bq = *(const u32x2*)(PB + (size_t)t * 512 + lane * 4);
    float ssq = bf_lo(bq.x) * bf_lo(bq.x) + bf_hi(bq.x) * bf_hi(bq.x) + bf_lo(bq.y) * bf_lo(bq.y) + bf_hi(bq.y) * bf_hi(bq.y);
    ssq = wave_sum(ssq);
    const float rsq = rsqrtf(ssq * (1.f / 256.f) + EPS);
    unsigned kpe = 0; if (lane >= 32 && lane < 48) kpe = *(const unsigned*)(PB + (size_t)t * 512 + 384 + (lane - 32) * 2);
    for (int h = 0; h < 8; ++h) {
      float x0 = 0.f, x1 = 0.f;
      bf16_t* qp = QM + (size_t)t * 768 + h * 96 + lane * 2;
      if (act) { const unsigned u = *(const unsigned*)qp; x0 = bf_lo(u) * rsq; x1 = bf_hi(u) * rsq; }
      float ss = wave_sum(x0 * x0 + x1 * x1);
      float rs = rsqrtf(ss * (1.f / 96.f) + EPS);
      x0 *= rs * gq0; x1 *= rs * gq1;
      float p0 = __shfl_xor(x0, 8), p1 = __shfl_xor(x1, 8);
      if (lane >= 32 && lane < 40) { x0 = x0 * c0 - p0 * s0; x1 = x1 * c1 - p1 * s1; }
      else if (lane >= 40 && lane < 48) { x0 = p0 * s0 + x0 * c0; x1 = p1 * s1 + x1 * c1; }
      if (act) *(unsigned*)qp = cvt_pk(x0, x1);
      x0 = 0.f; x1 = 0.f;
      if (lane < 32) { const unsigned u = *(const unsigned*)(KN + (size_t)t * 512 + h * 64 + lane * 2); x0 = bf_lo(u); x1 = bf_hi(u); }
      else if (lane < 48) { x0 = bf_lo(kpe); x1 = bf_hi(kpe); }
      ss = wave_sum(x0 * x0 + x1 * x1);
      rs = rsqrtf(ss * (1.f / 96.f) + EPS);
      x0 *= rs * gk0; x1 *= rs * gk1;
      p0 = __shfl_xor(x0, 8); p1 = __shfl_xor(x1, 8);
      if (lane >= 32 && lane < 40) { x0 = x0 * c0 - p0 * s0; x1 = x1 * c1 - p1 * s1; }
      else if (lane >= 40 && lane < 48) { x0 = p0 * s0 + x0 * c0; x1 = p1 * s1 + x1 * c1; }
      if (act) *(unsigned*)(KM + (size_t)t * 768 + h * 96 + lane * 2) = cvt_pk(x0, x1);
    }
  }
}


__device__ __forceinline__ void dbg_absmean(const bf16_t* buf, size_t n, float* slots, char* lds) {
  float s = 0.f;
  for (size_t i = (size_t)obid() * 256 + otid(); i < n; i += (size_t)gridDim.x * 256) { const float v = fabsf(bf2f(buf[i])); s += (v == v && v < 1e30f) ? v : 1e6f; }
  s = wave_sum(s);
  __syncthreads();
  if ((otid() & 63) == 0) ((float*)lds)[otid() >> 6] = s;
  __syncthreads();
  if (otid() == 0) slots[obid()] = (((float*)lds)[0] + ((float*)lds)[1] + ((float*)lds)[2] + ((float*)lds)[3]) / (float)n;
  __syncthreads();
}

__device__ __forceinline__ GemmDesc mk_gemm(const Params& p, int layer) {
  GemmDesc g; g.A = nullptr; g.A2 = nullptr; g.Bt = nullptr; g.Bt2 = nullptr; g.lda = 1024; g.lda2 = 1024; g.K = 1024; g.K2 = 1024; g.mt = T / 128; g.nt = 8; g.npass = 1;
  g.adil = 0; g.bbase = 0; g.bps = 0; g.bpt = 1 << 20; g.b2base = 0; g.kind = KIND_RES; g.accum = 0; g.layer = layer;
  return g;
}

__device__ __forceinline__ void run_phase(const Params& p, int layer, int ph, char* lds) {
  char* ws = pws(); char* R = ws + OFF_R;
  const bf16_t* W = (const bf16_t*)(ws + OFF_W);
  const bf16_t* H = (const bf16_t*)(ws + OFF_H);
  GemmDesc g = mk_gemm(p, layer);
  bool dog = false;
  switch (ph) {
    case 0: if (ON(0)) {
      conv_phase(p, layer, lds);
      if (layer == 0) { rope_phase(p); norm_rows(pin(0), pin(1), SP, T, pin(4), (bf16_t*)(ws + OFF_H), pout()); }
      else norm_rows(pout(), pout(), T, T, pin(4) + layer * 1024, (bf16_t*)(ws + OFF_H), nullptr);
      norm_rows(pin(2), pin(3), 256, NMEMROW, pin(24) + layer * 1024, (bf16_t*)(ws + OFF_MEMH), nullptr);
    } break;
    case 1: if (ON(1)) {
      g.A = H; g.Bt = W + W_IN; g.nt = 25; g.kind = KIND_PROJA; gemm_phase(p, g, lds);
      g = mk_gemm(p, layer); g.A = (const bf16_t*)(ws + OFF_MEMH); g.Bt = W + W_XKV; g.mt = NMEMROW / 128; g.nt = 16; g.kind = KIND_MEMKV; dog = true;
    } break;
    case 2: if (ON(2)) {
      for (int u = obid(); u < 288; u += gridDim.x) {
        int sid, rest;
        if (u < 32) { sid = 0; rest = u; } else { sid = 1 + (u - 32) / 32; rest = (u - 32) % 32; }
        gla_unit(p, lds, layer, sid, rest >> 3, (rest >> 2) & 1, rest & 3);
      }
      mem_post(p, layer);
    } break;
    case 3: if (ON(3)) gla_post(p, layer); break;
    case 4: if (ON(4)) {
      g.A = (const bf16_t*)(R + 3 * SLAB); g.Bt = W + W_A; g.npass = 2; g.A2 = H; g.Bt2 = W + W_IN; g.b2base = 12736; g.kind = KIND_MIX; g.accum = 0; gemm_phase(p, g, lds);
      g = mk_gemm(p, layer); g.A = H; g.Bt = W + W_IN; g.bbase = 3104; g.nt = 4; g.kind = KIND_PROJB; dog = true;
    } break;
    case 5: if (ON(5)) {
      g.A = (const bf16_t*)R; g.lda = 512; g.K = 256; g.Bt = W + W_UQ; g.nt = 6; g.kind = KIND_UQ; gemm_phase(p, g, lds);
      g = mk_gemm(p, layer); g.A = (const bf16_t*)R + 256; g.lda = 512; g.K = 128; g.Bt = W + W_UKV; g.nt = 12; g.kind = KIND_UKV; dog = true;
    } break;
    case 6: if (ON(6)) mla_post(p, layer); break;
    case 7: if (ON(7)) {
      const bf16_t* QM = (const bf16_t*)(R + SLAB); const bf16_t* KM = (const bf16_t*)(R + SLAB + 50331648ull); const bf16_t* VM = (const bf16_t*)(R + 2 * SLAB + SLAB / 2);
      bf16_t* OB = (bf16_t*)R;
      for (int u = obid(); u < 2048; u += gridDim.x) {
        int head, sb, S, qb;
        if (u < 1024) { head = u & 7; qb = u >> 3; sb = 0; S = SP; }
        else { const int v = u - 1024; head = v & 7; const int rest = v >> 3; sb = SP + (rest >> 4) * SS; S = SS; qb = rest & 15; }
        const int q0 = sb + qb * 128;
        attn_unit<96, 0, 2>(p, lds, QM + (size_t)q0 * 768 + head * 96, 768, KM + (size_t)sb * 768 + head * 96, 768, VM + (size_t)head * 128 * T + sb, T,
                         0, S / 64, 0, 0.10206207261596577f, nullptr, OB + (size_t)q0 * 1024 + head * 128, 1024, 0, 0, head, 1);
      }
    } break;
    case 8: if (ON(8)) {
      g.A = (const bf16_t*)R; g.Bt = W + W_B; g.npass = 2; g.A2 = H; g.Bt2 = W + W_IN; g.b2base = 12736 + 1024; g.kind = KIND_MIX; g.accum = 1; dog = true;
    } break;
    case 9: if (ON(9)) {
      const int grp = 0;
      g.A = H; g.Bt = W + W_IN; g.nt = 24; g.bbase = 3520 + grp * 1024; g.bps = 3072; g.bpt = 8; g.adil = 1; g.kind = KIND_PROJC; dog = true;
    } break;
    case 10: if (ON(10)) {
      const int grp = 0, dil = 1;
      const bf16_t* Qd = (const bf16_t*)R; const bf16_t* Kd = (const bf16_t*)(R + SLAB); const bf16_t* Vd = (const bf16_t*)(R + 2 * SLAB);
      bf16_t* OC = (bf16_t*)(R + 3 * SLAB);
      for (int u = obid(); u < 2048; u += gridDim.x) {
        const int head = u & 7, qb = u >> 3;
        const int g0 = qb * 128;
        int base, S; if (g0 < SP) { base = 0; S = SP; } else { base = SP + ((g0 - SP) / SS) * SS; S = SS; }
        const int L = S / dil, l0 = g0 - base, sub0 = base + (l0 / L) * L, qi0 = l0 % L;
        int tb = (qi0 - 64) >> 6, te = (qi0 + 192) >> 6; if (tb < 0) tb = 0; if (te > L / 64) te = L / 64;
        attn_unit<128, 1, 2>(p, lds, Qd + (size_t)g0 * 1024 + head * 128, 1024, Kd + (size_t)sub0 * 1024 + head * 128, 1024, Vd + (size_t)head * 128 * T + sub0, T,
                          tb, te, qi0, 0.08838834764831845f, nullptr, OC + head * 128, 1024, grp, g0, head, dil);
      }
    } break;
    case 11: if (ON(9)) {
      const int grp = 1;
      g.A = H; g.Bt = W + W_IN; g.nt = 24; g.bbase = 3520 + grp * 1024; g.bps = 3072; g.bpt = 8; g.adil = 4; g.kind = KIND_PROJC; dog = true;
    } break;
    case 12: if (ON(10)) {
      const int grp = 1, dil = 4;
      const bf16_t* Qd = (const bf16_t*)R; const bf16_t* Kd = (const bf16_t*)(R + SLAB); const bf16_t* Vd = (const bf16_t*)(R + 2 * SLAB);
      bf16_t* OC = (bf16_t*)(R + 3 * SLAB);
      for (int u = obid(); u < 2048; u += gridDim.x) {
        const int head = u & 7, qb = u >> 3;
        const int g0 = qb * 128;
        int base, S; if (g0 < SP) { base = 0; S = SP; } else { base = SP + ((g0 - SP) / SS) * SS; S = SS; }
        const int L = S / dil, l0 = g0 - base, sub0 = base + (l0 / L) * L, qi0 = l0 % L;
        int tb = (qi0 - 64) >> 6, te = (qi0 + 192) >> 6; if (tb < 0) tb = 0; if (te > L / 64) te = L / 64;
        attn_unit<128, 1, 2>(p, lds, Qd + (size_t)g0 * 1024 + head * 128, 1024, Kd + (size_t)sub0 * 1024 + head * 128, 1024, Vd + (size_t)head * 128 * T + sub0, T,
                          tb, te, qi0, 0.08838834764831845f, nullptr, OC + head * 128, 1024, grp, g0, head, dil);
      }
    } break;
    case 13: if (ON(9)) {
      const int grp = 2;
      g.A = H; g.Bt = W + W_IN; g.nt = 24; g.bbase = 3520 + grp * 1024; g.bps = 3072; g.bpt = 8; g.adil = 16; g.kind = KIND_PROJC; dog = true;
    } break;
    case 14: if (ON(10)) {
      const int grp = 2, dil = 16;
      const bf16_t* Qd = (const bf16_t*)R; const bf16_t* Kd = (const bf16_t*)(R + SLAB); const bf16_t* Vd = (const bf16_t*)(R + 2 * SLAB);
      bf16_t* OC = (bf16_t*)(R + 3 * SLAB);
      for (int u = obid(); u < 2048; u += gridDim.x) {
        const int head = u & 7, qb = u >> 3;
        const int g0 = qb * 128;
        int base, S; if (g0 < SP) { base = 0; S = SP; } else { base = SP + ((g0 - SP) / SS) * SS; S = SS; }
        const int L = S / dil, l0 = g0 - base, sub0 = base + (l0 / L) * L, qi0 = l0 % L;
        int tb = (qi0 - 64) >> 6, te = (qi0 + 192) >> 6; if (tb < 0) tb = 0; if (te > L / 64) te = L / 64;
        attn_unit<128, 1, 2>(p, lds, Qd + (size_t)g0 * 1024 + head * 128, 1024, Kd + (size_t)sub0 * 1024 + head * 128, 1024, Vd + (size_t)head * 128 * T + sub0, T,
                          tb, te, qi0, 0.08838834764831845f, nullptr, OC + head * 128, 1024, grp, g0, head, dil);
      }
    } break;
    case 15: if (ON(15)) {
      g.A = (const bf16_t*)(R + 3 * SLAB); g.Bt = W + W_C; g.npass = 2; g.A2 = H; g.Bt2 = W + W_IN; g.b2base = 12736 + 2048; g.kind = KIND_MIX; g.accum = 1; dog = true;
    } break;
    case 16: if (ON(16)) { g.A = ON(4) ? (const bf16_t*)(R + 4 * SLAB) : (ON(3) ? (const bf16_t*)(R + 3 * SLAB) : H); g.Bt = W + W_O; g.kind = KIND_RES; dog = true; } break;
    case 17: if (ON(17)) norm_rows(pout(), pout(), T, T, pin(23) + layer * 1024, (bf16_t*)(ws + OFF_H), nullptr); break;
    case 18: if (ON(18)) { g.A = H; g.Bt = W + W_XQ; g.kind = KIND_XQ; dog = true; } break;
    case 19: if (ON(19)) {
      const bf16_t* QX = (const bf16_t*)R; const bf16_t* KX = (const bf16_t*)(ws + OFF_KX); const bf16_t* VX = (const bf16_t*)(ws + OFF_VTX);
      bf16_t* OX = (bf16_t*)(R + SLAB);
      for (int u = obid(); u < 4096; u += gridDim.x) {
        const int half = u & 1, head = (u >> 1) & 3, qb = u >> 3, q0 = qb * 64;
        const int sid = q0 < SP ? 0 : 1 + (q0 - SP) / SS;
        attn_unit<256, 2, 1>(p, lds, QX + (size_t)q0 * 1024 + head * 256, 1024, KX + (size_t)sid * 256 * 1024 + head * 256, 1024,
                          VX + (size_t)((sid * 4 + head) * 256 + half * 128) * 256, 256, 0, 4, 0, 0.0625f, pin(27) + layer * 256,
                          OX + (size_t)q0 * 1024 + head * 256 + half * 128, 1024, 0, 0, head, 1);
      }
    } break;
    case 20: if (ON(20)) { g.A = (const bf16_t*)(R + SLAB); g.Bt = W + W_XO; g.kind = KIND_RES; dog = true; } break;
    case 21: if (ON(21)) norm_rows(pout(), pout(), T, T, pin(30) + layer * 1024, (bf16_t*)(ws + OFF_H), nullptr); break;
    case 22: if (ON(22)) { g.A = H; g.Bt = W + W_F1; g.nt = 32; g.kind = KIND_FF1; dog = true; } break;
    case 23: if (ON(23)) { g.A = (const bf16_t*)R; g.lda = 4096; g.K = 4096; g.Bt = W + W_F2; g.kind = KIND_RES; dog = true; } break;
    default: break;
  }
  if (ON(24) && dog) gemm_phase(p, g, lds);
}

constexpr int NPHASE = 24;

__device__ __forceinline__ void grid_barrier(unsigned* ctr, unsigned& epoch) {
  asm volatile("s_waitcnt vmcnt(0)" ::: "memory");
  __syncthreads();
  epoch += gridDim.x;
  if (threadIdx.x == 0) {
    __builtin_amdgcn_fence(__ATOMIC_RELEASE, "agent");
    asm volatile("s_waitcnt vmcnt(0)" ::: "memory");
    __hip_atomic_fetch_add(ctr, 1u, __ATOMIC_RELAXED, __HIP_MEMORY_SCOPE_AGENT);
    while (__hip_atomic_load(ctr, __ATOMIC_RELAXED, __HIP_MEMORY_SCOPE_AGENT) < epoch) __builtin_amdgcn_s_sleep(2);
    __builtin_amdgcn_fence(__ATOMIC_ACQUIRE, "agent");
    asm volatile("s_waitcnt vmcnt(0)" ::: "memory");
  }
  __syncthreads();
}

__global__ void __launch_bounds__(256, 2) mega(Params p, int ph_lo, int ph_hi) {
  extern __shared__ __attribute__((aligned(16))) char lds[];
#if !MULTI_LAUNCH
  cg::grid_group grid = cg::this_grid();
  grid.sync();
  unsigned* bar = (unsigned*)(pws() + OFF_BAR);
  unsigned epoch = 0;
#endif
#ifdef ZFILL
  {
    u32x4* z = (u32x4*)(pws() + OFF_R);
    const size_t n = (WS_NEED - OFF_R) / 16;
    for (size_t i = (size_t)blockIdx.x * 256 + threadIdx.x; i < n; i += (size_t)gridDim.x * 256) z[i] = (u32x4){0u, 0u, 0u, 0u};
    __threadfence(); grid.sync(); __threadfence();
  }
#endif
  for (int gp = ph_lo; gp < ph_hi; ++gp) {
    const int layer = gp / NPHASE, ph = gp % NPHASE;
    run_phase(p, layer, ph, lds);
#ifdef DBG
    if (layer == 0 && ph == 9) {
      grid_barrier(bar, epoch);
      float* st = (float*)(pws() + OFF_DBG);
      dbg_absmean((const bf16_t*)(pws() + OFF_W) + W_IN + (size_t)9664 * 1024, (size_t)3072 * 1024, st, lds);
      dbg_absmean((const bf16_t*)(pws() + OFF_R + 2 * SLAB), (size_t)T * 1024, st + 1024, lds);
    }
    if (layer == 1 && ph == NPHASE - 1) {
      grid_barrier(bar, epoch);
      const float* st = (const float*)(pws() + OFF_DBG);
      float a = 0.f, b = 0.f;
      for (unsigned i = 0; i < gridDim.x; ++i) { a += st[i]; b += st[1024 + i]; }
      a = fminf(a * 32.f, 2.f); b = fminf(b, 2.f);
      for (size_t i = (size_t)obid() * 256 + otid(); i < (size_t)T * 1024; i += (size_t)gridDim.x * 256) pout()[i] *= (1.f + 0.3f * b);
      grid_barrier(bar, epoch);
      if (obid() == 0 && otid() == 0) pout()[0] += 10.f + 100.f * a;
    }
#endif
#if !MULTI_LAUNCH
    if (gp + 1 < ph_hi) grid_barrier(bar, epoch);
#endif
  }
}

extern "C" void kernel_launch(void* const* d_in, const int* in_sizes, int n_in, void* d_out, int out_size, void* d_ws, size_t ws_size, hipStream_t stream) {
  if (ws_size < WS_NEED) { (void)hipMemsetAsync(d_out, 0, (size_t)out_size * 4, stream); return; }
  Params p{};
  for (int i = 0; i < 33; ++i) p.in[i] = (const float*)d_in[i];
  p.out = (float*)d_out; p.ws = (char*)d_ws;
  static int grid_blocks = 0;
  if (!grid_blocks) {
    int dev = 0, cus = 0, per_cu = 0;
    hipGetDevice(&dev);
    hipDeviceGetAttribute(&cus, hipDeviceAttributeMultiprocessorCount, dev);
    hipFuncSetAttribute((const void*)mega, hipFuncAttributeMaxDynamicSharedMemorySize, LDS_BYTES);
    hipOccupancyMaxActiveBlocksPerMultiprocessor(&per_cu, mega, 256, LDS_BYTES);
    if (per_cu > 2) per_cu = 2;
    grid_blocks = cus * per_cu;
  }
#if MULTI_LAUNCH
  for (int gp = 0; gp < 2 * NPHASE; ++gp) hipLaunchKernelGGL(mega, dim3(grid_blocks), dim3(256), LDS_BYTES, stream, p, gp, gp + 1);
#else
  (void)hipMemsetAsync((char*)d_ws + OFF_BAR, 0, 256, stream);
  int lo = 0, hi = 2 * NPHASE;
  void* args[] = {&p, &lo, &hi};
  hipError_t e = hipLaunchCooperativeKernel((void*)mega, dim3(grid_blocks), dim3(256), args, LDS_BYTES, stream);
  if (e != hipSuccess) { fprintf(stderr, "cooperative launch failed: %s (grid %d)\n", hipGetErrorString(e), grid_blocks); (void)hipMemsetAsync(d_out, 0xff, (size_t)out_size * 4, stream); }
#endif
}
```
